# Optimizing an MI355X kernel written in HIP

```python
import math
import jax, jax.numpy as jnp
from jax import lax
import numpy as np

D_MODEL = 1024
BATCH = 8
SEQ = 4096
DEPTH = 1

MIX_WIDTH = D_MODEL
ATTN_WIDTH = MIX_WIDTH // 2
POOL_WIDTH = MIX_WIDTH - ATTN_WIDTH
HEAD_DIM = 64
N_HEADS = ATTN_WIDTH // HEAD_DIM
POOL_WINDOWS = (2, 4, 8, 16)
N_POOL_GROUPS = len(POOL_WINDOWS)
POOL_GROUP = POOL_WIDTH // N_POOL_GROUPS
D_FF = 4 * D_MODEL
PLE_DIM = 256
Q_BLOCK = 128
LN_EPS = 1e-5
RMS_EPS = 1e-6
DN_ALPHA = float((2 * DEPTH) ** 0.25)
DN_BETA = float((8 * DEPTH) ** -0.25)
PROJ_WIDTH = 3 * ATTN_WIDTH + POOL_WIDTH

kernel_name = "hymba_stickbreak_pool_deepnorm"


def layer_norm(x, g, b):
    xf = x.astype(jnp.float32)
    mu = jnp.mean(xf, axis=-1, keepdims=True)
    var = jnp.mean(jnp.square(xf - mu), axis=-1, keepdims=True)
    y = (xf - mu) * lax.rsqrt(var + LN_EPS)
    return (y * g.astype(jnp.float32) + b.astype(jnp.float32)).astype(x.dtype)


def stick_breaking_attention(q, k, v):
    B, H, S, Dh = q.shape
    n_blk = S // Q_BLOCK
    scale = 1.0 / math.sqrt(Dh)
    q_blocks = q.reshape(B, H, n_blk, Q_BLOCK, Dh).transpose(2, 0, 1, 3, 4)
    starts = jnp.arange(n_blk, dtype=jnp.int32) * Q_BLOCK
    k_pos = jnp.arange(S, dtype=jnp.int32)
    kf = k.astype(jnp.float32)
    vf = v.astype(jnp.float32)

    def one_block(args):
        q_blk, start = args
        z = jnp.einsum("bhqd,bhkd->bhqk", q_blk.astype(jnp.float32), kf) * scale
        q_pos = start + jnp.arange(Q_BLOCK, dtype=jnp.int32)
        mask = k_pos[None, :] < q_pos[:, None]
        log_not = jnp.where(mask, jax.nn.log_sigmoid(-z), 0.0)
        suffix = lax.cumsum(log_not, axis=3, reverse=True) - log_not
        weights = jnp.where(mask, jnp.exp(jax.nn.log_sigmoid(z) + suffix), 0.0)
        return jnp.einsum("bhqk,bhkd->bhqd", weights, vf)

    out = lax.map(one_block, (q_blocks, starts))
    return out.transpose(1, 2, 0, 3, 4).reshape(B, H, S, Dh)


def multiscale_pool(u, w_pool, pool_scale):
    B, S, _ = u.shape
    uf = u.astype(jnp.float32)
    csum = jnp.cumsum(uf, axis=1)
    pos = jnp.arange(S, dtype=jnp.int32)
    diffs = []
    for g, w in enumerate(POOL_WINDOWS):
        sl = slice(g * POOL_GROUP, (g + 1) * POOL_GROUP)
        cg = csum[..., sl]
        lag = jnp.pad(cg, ((0, 0), (w, 0), (0, 0)))[:, :S]
        count = jnp.minimum(pos + 1, w).astype(jnp.float32)[None, :, None]
        diffs.append((cg - lag) / count - uf[..., sl])
    d = jnp.stack(diffs, axis=2)
    y = jnp.einsum("bsgc,gcd->bsgd", d, w_pool.astype(jnp.float32))
    return y.reshape(B, S, POOL_WIDTH) * pool_scale.astype(jnp.float32)


def setup_inputs(seed: int = 0) -> dict:
    key = jax.random.key(seed)
    ks = jax.random.split(key, 24)
    nrm = lambda k, shape, s: jax.random.normal(k, shape, jnp.float32) * s
    L = DEPTH
    x = jax.random.normal(ks[0], (BATCH, SEQ, D_MODEL), jnp.float32)
    p = jax.random.normal(ks[1], (L, BATCH, SEQ, PLE_DIM), jnp.float32)
    emb_ln_g = 1.0 + nrm(ks[2], (D_MODEL,), 0.02)
    emb_ln_b = nrm(ks[3], (D_MODEL,), 0.02)
    col_scale = jnp.concatenate([
        jnp.ones((2 * ATTN_WIDTH,), jnp.float32),
        jnp.full((ATTN_WIDTH + POOL_WIDTH,), DN_BETA, jnp.float32)])
    w_in = nrm(ks[4], (L, D_MODEL, PROJ_WIDTH), D_MODEL ** -0.5) * col_scale
    attn_out_g = 1.0 + nrm(ks[5], (L, ATTN_WIDTH), 0.02)
    w_pool = nrm(ks[6], (L, N_POOL_GROUPS, POOL_GROUP, POOL_GROUP), POOL_GROUP ** -0.5 * DN_BETA)
    pool_scale = 1.0 + nrm(ks[7], (L, POOL_WIDTH), 0.02)
    w_out = nrm(ks[8], (L, MIX_WIDTH, D_MODEL), MIX_WIDTH ** -0.5 * DN_BETA)
    ln1_g = 1.0 + nrm(ks[9], (L, D_MODEL), 0.02)
    ln1_b = nrm(ks[10], (L, D_MODEL), 0.02)
    w_up = nrm(ks[11], (L, D_MODEL, D_FF), D_MODEL ** -0.5 * DN_BETA)
    w_down = nrm(ks[12], (L, D_FF, D_MODEL), D_FF ** -0.5 * DN_BETA)
    ln2_g = 1.0 + nrm(ks[13], (L, D_MODEL), 0.02)
    ln2_b = nrm(ks[14], (L, D_MODEL), 0.02)
    w_ple = nrm(ks[15], (L, PLE_DIM, D_MODEL), PLE_DIM ** -0.5 * DN_BETA)
    w_ple_gate = nrm(ks[16], (L, D_MODEL, D_MODEL), D_MODEL ** -0.5)
    ln3_g = 1.0 + nrm(ks[17], (L, D_MODEL), 0.02)
    ln3_b = nrm(ks[18], (L, D_MODEL), 0.02)
    return {"x": x, "p": p, "emb_ln_g": emb_ln_g, "emb_ln_b": emb_ln_b,
            "w_in": w_in, "attn_out_g": attn_out_g, "w_pool": w_pool, "pool_scale": pool_scale,
            "w_out": w_out, "ln1_g": ln1_g, "ln1_b": ln1_b, "w_up": w_up, "w_down": w_down,
            "ln2_g": ln2_g, "ln2_b": ln2_b, "w_ple": w_ple, "w_ple_gate": w_ple_gate,
            "ln3_g": ln3_g, "ln3_b": ln3_b}


def reference(x, p, emb_ln_g, emb_ln_b, w_in, attn_out_g, w_pool, pool_scale, w_out,
              ln1_g, ln1_b, w_up, w_down, ln2_g, ln2_b, w_ple, w_ple_gate, ln3_g, ln3_b):
    B, S, D = x.shape
    dt = x.dtype
    x = layer_norm(x, emb_ln_g, emb_ln_b)
    for i in range(DEPTH):
        proj = x @ w_in[i]
        q, k, v, u = jnp.split(proj, [ATTN_WIDTH, 2 * ATTN_WIDTH, 3 * ATTN_WIDTH], axis=-1)
        to_heads = lambda t: t.reshape(B, S, N_HEADS, HEAD_DIM).transpose(0, 2, 1, 3)
        o = stick_breaking_attention(to_heads(q), to_heads(k), to_heads(v))
        o = o * lax.rsqrt(jnp.mean(o * o, axis=-1, keepdims=True) + RMS_EPS)
        o = o.transpose(0, 2, 1, 3).reshape(B, S, ATTN_WIDTH) * attn_out_g[i].astype(jnp.float32)
        pooled = multiscale_pool(u, w_pool[i], pool_scale[i])
        mixed = jnp.concatenate([o, pooled], axis=-1).astype(dt) @ w_out[i]
        x = layer_norm(DN_ALPHA * x + mixed, ln1_g[i], ln1_b[i])
        h = jnp.square(jax.nn.relu(x @ w_up[i])) @ w_down[i]
        x = layer_norm(DN_ALPHA * x + h, ln2_g[i], ln2_b[i])
        ple = (p[i] @ w_ple[i]) * jax.nn.sigmoid(x @ w_ple_gate[i])
        x = layer_norm(DN_ALPHA * x + ple, ln3_g[i], ln3_b[i])
    return x
```

```cpp
#include <hip/hip_runtime.h>
#include <hip/hip_cooperative_groups.h>
#include <cstdio>
#include <cstdint>
namespace cg = cooperative_groups;
namespace pg8 {
#define PG8_LAS __attribute__((address_space(3)))
typedef unsigned short bf16_t;
typedef short bf16x8 __attribute__((ext_vector_type(8)));
typedef float f32x4 __attribute__((ext_vector_type(4)));
typedef unsigned u32x4 __attribute__((ext_vector_type(4)));
constexpr int BM = 256, BK = 64, HALF = 128, HTB = HALF * BK * 2  , STAGE_BYTES = 8 * HTB, NXCD = 8, WGM = 8;

__host__ __device__ __forceinline__ int lds_byte(int r, int c) { const int st = (r >> 4) * 2 + (c >> 5), rr = r & 15, cc = c & 31, ob = rr * 64 + cc * 2; return st * 1024 + (ob ^ (((ob >> 9) & 1) << 5)); }
__host__ __device__ __forceinline__ void stage_rc(int b, int& R, int& C) { const int st = b / 1024, sb = b % 1024, swz = sb ^ (((sb >> 9) & 1) << 5); R = (st >> 1) * 16 + swz / 64; C = (st & 1) * 32 + (swz % 64) / 2; }
__host__ __device__ __forceinline__ int perm32(int rho) { const int n = rho >> 4, i = rho & 15; return 8 * (i >> 2) + 4 * n + (i & 3); }

struct Unit { int pm, pn; };
struct Gemm { const bf16_t* A; const bf16_t* Bt; int M, N, K; };

struct StaticOrder {
    int nM, nN, nwg, G, c;
    __host__ __device__ void init(int M, int N, int G_, int c_) { nM = M / BM; nN = N / BM; nwg = nM * nN; G = G_; c = c_; }
    __host__ __device__ bool next(int i, Unit& u) const {
        const long L = (long)i * G + c; if (L >= nwg) return false;
        int wgid = (int)L; { const int q = nwg / NXCD, r = nwg % NXCD, xcd = wgid % NXCD, off = wgid / NXCD; wgid = (xcd < r ? xcd * (q + 1) : r * (q + 1) + (xcd - r) * q) + off; }
        const int nig = WGM * nN, gid = wgid / nig, fm = gid * WGM, gsz = (nM - fm) < WGM ? (nM - fm) : WGM;
        u.pm = fm + ((wgid % nig) % gsz); u.pn = (wgid % nig) / gsz; return true;
    }
    __device__ __forceinline__ void a_ready(const Unit&) const {}
    __device__ __forceinline__ void done(const Unit&) const {}
};

typedef float f32x2c_t __attribute__((ext_vector_type(2))); typedef __bf16 bf16x2c_t __attribute__((ext_vector_type(2)));
__device__ __forceinline__ unsigned cvt_pk_bf16(float lo, float hi) { f32x2c_t v = {lo, hi}; bf16x2c_t b = __builtin_convertvector(v, bf16x2c_t); return __builtin_bit_cast(unsigned, b); }
typedef float f32x2 __attribute__((ext_vector_type(2)));
__device__ __forceinline__ float bf_lo(unsigned w) { return __uint_as_float(w << 16); }
__device__ __forceinline__ float bf_hi(unsigned w) { return __uint_as_float(w & 0xffff0000u); }
template <int ACT> struct EpiBf16 {
    static constexpr bool PERM = true, AFTER_DRAIN = false;
    bf16_t* O; int ldc; int split_cols; size_t split_stride; float scale0;
    __device__ __forceinline__ void operator()(const f32x4 (&acc)[2][2][4][2], const Unit& u, int wr, int wc, int fr, int fq) const {
        const int row0 = u.pm * BM + wr * 64 + fr; int colt = u.pn * BM; bf16_t* base = O;
        float sc = 1.f; if (split_cols) { const int t = colt / split_cols; base += (size_t)t * split_stride; colt -= t * split_cols; if (t == 0) sc = scale0; }
        const int col0 = colt + wc * 32 + 8 * fq;
#pragma unroll
        for (int ai = 0; ai < 2; ++ai)
#pragma unroll
            for (int m = 0; m < 4; ++m) { bf16_t* rowp = base + (size_t)(row0 + ai * HALF + m * 16) * ldc + col0;
#pragma unroll
                for (int bj = 0; bj < 2; ++bj) { f32x4 v0 = acc[ai][bj][m][0], v1 = acc[ai][bj][m][1];
                    if (ACT == 2) {
#pragma unroll
                        for (int e = 0; e < 4; ++e) { const float a = fmaxf(v0[e], 0.f), b = fmaxf(v1[e], 0.f); v0[e] = a * a; v1[e] = b * b; } }
                    v0 = v0 * sc; v1 = v1 * sc; u32x4 w; w.x = cvt_pk_bf16(v0[0], v0[1]); w.y = cvt_pk_bf16(v0[2], v0[3]); w.z = cvt_pk_bf16(v1[0], v1[1]); w.w = cvt_pk_bf16(v1[2], v1[3]);
                    *(u32x4*)(rowp + bj * HALF) = w; } }
    }
};
struct EpiRes {
    static constexpr bool PERM = true, AFTER_DRAIN = false;
    const bf16_t* R; float* Y; int ldc; float alpha;
    __device__ __forceinline__ void operator()(const f32x4 (&acc)[2][2][4][2], const Unit& u, int wr, int wc, int fr, int fq) const {
        const int row0 = u.pm * BM + wr * 64 + fr, col0 = u.pn * BM + wc * 32 + 8 * fq;
#pragma unroll
        for (int ai = 0; ai < 2; ++ai)
#pragma unroll
            for (int m = 0; m < 4; ++m) { const size_t off = (size_t)(row0 + ai * HALF + m * 16) * ldc + col0;
#pragma unroll
                for (int bj = 0; bj < 2; ++bj) { const u32x4 rv = *(const u32x4*)(R + off + bj * HALF); f32x4 v0 = acc[ai][bj][m][0], v1 = acc[ai][bj][m][1];
                    v0[0] += alpha * bf_lo(rv.x); v0[1] += alpha * bf_hi(rv.x); v0[2] += alpha * bf_lo(rv.y); v0[3] += alpha * bf_hi(rv.y);
                    v1[0] += alpha * bf_lo(rv.z); v1[1] += alpha * bf_hi(rv.z); v1[2] += alpha * bf_lo(rv.w); v1[3] += alpha * bf_hi(rv.w);
                    *(f32x4*)(Y + off + bj * HALF) = v0; *(f32x4*)(Y + off + bj * HALF + 4) = v1; } }
    }
};
struct EpiGate {
    static constexpr bool PERM = true, AFTER_DRAIN = false;
    const bf16_t* R; const bf16_t* P; float* Y; int ldc; float alpha;
    __device__ __forceinline__ float sg(float a) const { return __builtin_amdgcn_rcpf(1.f + __builtin_amdgcn_exp2f(-1.4426950408889634f * a)); }
    __device__ __forceinline__ void operator()(const f32x4 (&acc)[2][2][4][2], const Unit& u, int wr, int wc, int fr, int fq) const {
        const int row0 = u.pm * BM + wr * 64 + fr, col0 = u.pn * BM + wc * 32 + 8 * fq;
#pragma unroll
        for (int ai = 0; ai < 2; ++ai)
#pragma unroll
            for (int m = 0; m < 4; ++m) { const size_t off = (size_t)(row0 + ai * HALF + m * 16) * ldc + col0;
#pragma unroll
                for (int bj = 0; bj < 2; ++bj) { const u32x4 rv = *(const u32x4*)(R + off + bj * HALF); const u32x4 pv = *(const u32x4*)(P + off + bj * HALF);
                    const f32x4 a0 = acc[ai][bj][m][0], a1 = acc[ai][bj][m][1]; f32x4 v0, v1;
                    v0[0] = alpha * bf_lo(rv.x) + bf_lo(pv.x) * sg(a0[0]); v0[1] = alpha * bf_hi(rv.x) + bf_hi(pv.x) * sg(a0[1]);
                    v0[2] = alpha * bf_lo(rv.y) + bf_lo(pv.y) * sg(a0[2]); v0[3] = alpha * bf_hi(rv.y) + bf_hi(pv.y) * sg(a0[3]);
                    v1[0] = alpha * bf_lo(rv.z) + bf_lo(pv.z) * sg(a1[0]); v1[1] = alpha * bf_hi(rv.z) + bf_hi(pv.z) * sg(a1[1]);
                    v1[2] = alpha * bf_lo(rv.w) + bf_lo(pv.w) * sg(a1[2]); v1[3] = alpha * bf_hi(rv.w) + bf_hi(pv.w) * sg(a1[3]);
                    *(f32x4*)(Y + off + bj * HALF) = v0; *(f32x4*)(Y + off + bj * HALF + 4) = v1; } }
    }
};
template <class Epi, class Sched, bool ALIGN_EPI = false, bool SP2 = false>
__device__ __forceinline__ void gemm_phase(PG8_LAS unsigned char* lds, const Gemm g, const Sched& S, const Epi& E) {
    const int tid = threadIdx.x, wid = __builtin_amdgcn_readfirstlane(tid >> 6), lane = tid & 63, wr = wid >> 2, wc = wid & 3, fr = lane & 15, fq = lane >> 4;
    const int K = g.K, nt = K / BK;
    unsigned voffA[2], voffB[2];
#pragma unroll
    for (int i = 0; i < 2; ++i) { int R, C; stage_rc(tid * 16 + i * 8192, R, C); const int Rb = Epi::PERM ? ((R & ~31) + perm32(R & 31)) : R;
        voffA[i] = (unsigned)(R * K + C) * 2u; voffB[i] = (unsigned)(Rb * K + C) * 2u; }
    const size_t kstep = (size_t)(BK * 2);
    const size_t hstep = (size_t)HALF * K * 2;
    const size_t tstep = 2 * hstep;
    const unsigned ldsw = (unsigned)wid * 1024u;
    const int aoff = lds_byte(wr * 64 + fr, fq * 8), boff = lds_byte(wc * 32 + fr, fq * 8);
#define PG8_SA(b, h) (((b) * 2 + (h)) * HTB)
#define PG8_SB(b, h) ((4 + (b) * 2 + (h)) * HTB)
#define PG8_STAGE(bufoff, gbase, voff) do { _Pragma("unroll") for (int _i = 0; _i < 2; ++_i) \
        __builtin_amdgcn_global_load_lds((const unsigned*)((const char*)(gbase) + (voff)[_i]), (PG8_LAS unsigned*)(lds + (bufoff) + ldsw + _i * 8192), 16, 0, 0); } while (0)
#define PG8_LDA(dst, b, h) do { _Pragma("unroll") for (int m = 0; m < 4; ++m) _Pragma("unroll") for (int k = 0; k < 2; ++k) dst[m][k] = *(const PG8_LAS bf16x8*)(lds + PG8_SA(b, h) + aoff + m * 2048 + k * 1024); } while (0)
#define PG8_LDB(dst, b, h) do { _Pragma("unroll") for (int n = 0; n < 2; ++n) _Pragma("unroll") for (int k = 0; k < 2; ++k) dst[n][k] = *(const PG8_LAS bf16x8*)(lds + PG8_SB(b, h) + boff + n * 2048 + k * 1024); } while (0)
#define PG8_MMA(ai, bj, At, Bt) do { __builtin_amdgcn_s_setprio(1); _Pragma("unroll") for (int m = 0; m < 4; ++m) _Pragma("unroll") for (int n = 0; n < 2; ++n) _Pragma("unroll") for (int k = 0; k < 2; ++k) \
        acc[ai][bj][m][n] = __builtin_amdgcn_mfma_f32_16x16x32_bf16(Bt[n][k], At[m][k], acc[ai][bj][m][n], 0, 0, 0); __builtin_amdgcn_s_setprio(0); } while (0)
#define PG8_WAIT_V(n) asm volatile("s_waitcnt vmcnt(" #n ")" ::: "memory")
#define PG8_WAIT_L(n) asm volatile("s_waitcnt lgkmcnt(" #n ")" ::: "memory")
#define PG8_BAR __builtin_amdgcn_s_barrier()
#define PG8_SCHED __builtin_amdgcn_sched_barrier(0)
    Unit cur, nxt; int ui = 0;
    if (!S.next(0, cur)) return;
    f32x4 acc[2][2][4][2];
#pragma unroll
    for (int a = 0; a < 2; ++a)
#pragma unroll
        for (int b = 0; b < 2; ++b)
#pragma unroll
            for (int m = 0; m < 4; ++m)
#pragma unroll
                for (int n = 0; n < 2; ++n) acc[a][b][m][n] = (f32x4){0.f, 0.f, 0.f, 0.f};
    bf16x8 At[4][2], B0[2][2], B1[2][2];
    const char* cA = (const char*)g.A + (size_t)cur.pm * tstep; const char* cB = (const char*)g.Bt + (size_t)cur.pn * tstep;
    S.a_ready(cur);
    if constexpr (SP2) {
        PG8_STAGE(PG8_SB(0, 0), cB, voffB); PG8_STAGE(PG8_SB(0, 1), cB + hstep, voffB); PG8_STAGE(PG8_SA(0, 0), cA, voffA); PG8_STAGE(PG8_SA(0, 1), cA + hstep, voffA);
        if (wr == 1) PG8_BAR;
        PG8_WAIT_V(2); PG8_BAR;
        PG8_STAGE(PG8_SB(1, 0), cB + kstep, voffB); PG8_STAGE(PG8_SA(1, 0), cA + kstep, voffA); PG8_STAGE(PG8_SB(1, 1), cB + hstep + kstep, voffB);
        PG8_WAIT_V(6); PG8_BAR;
    } else {
        PG8_STAGE(PG8_SB(0, 0), cB, voffB); PG8_STAGE(PG8_SA(0, 0), cA, voffA); PG8_STAGE(PG8_SB(0, 1), cB + hstep, voffB); PG8_STAGE(PG8_SA(0, 1), cA + hstep, voffA);
        if (wr == 1) PG8_BAR;
        PG8_WAIT_V(4); PG8_BAR;
        PG8_STAGE(PG8_SB(1, 0), cB + kstep, voffB); PG8_STAGE(PG8_SA(1, 0), cA + kstep, voffA); PG8_STAGE(PG8_SB(1, 1), cB + hstep + kstep, voffB);
        PG8_WAIT_V(6); PG8_BAR;
    }
    for (;;) {
        const bool has_next = S.next(ui + 1, nxt);
        const char* nA = has_next ? (const char*)g.A + (size_t)nxt.pm * tstep : cA; const char* nB = has_next ? (const char*)g.Bt + (size_t)nxt.pn * tstep : cB;
        for (int t = 0; t < nt; t += 2) {
            const bool last = (t == nt - 2);
            const char* a1 = cA + (size_t)(t + 1) * kstep;
            const char* a2 = last ? nA : cA + (size_t)(t + 2) * kstep; const char* b2 = last ? nB : cB + (size_t)(t + 2) * kstep;
            const char* a3 = a2 + kstep; const char* b3 = b2 + kstep;
            if (last && has_next) S.a_ready(nxt);
            if constexpr (SP2) {
            PG8_LDB(B0, 0, 0); PG8_LDB(B1, 0, 1); PG8_SCHED; PG8_LDA(At, 0, 0); PG8_STAGE(PG8_SA(1, 1), a1 + hstep, voffA);
            PG8_WAIT_V(8); PG8_WAIT_L(0); PG8_BAR; PG8_MMA(0, 0, At, B0); PG8_MMA(0, 1, At, B1); PG8_BAR; PG8_SCHED;
            PG8_LDA(At, 0, 1); PG8_STAGE(PG8_SB(0, 0), b2, voffB); PG8_STAGE(PG8_SB(0, 1), b2 + hstep, voffB); PG8_STAGE(PG8_SA(0, 0), a2, voffA);
            PG8_WAIT_V(8); PG8_WAIT_L(0); PG8_BAR; PG8_MMA(1, 0, At, B0); PG8_MMA(1, 1, At, B1); PG8_BAR; PG8_SCHED;
            PG8_LDB(B0, 1, 0); PG8_LDB(B1, 1, 1); PG8_SCHED; PG8_LDA(At, 1, 0); PG8_STAGE(PG8_SA(0, 1), a2 + hstep, voffA);
            PG8_WAIT_V(8); PG8_WAIT_L(0); PG8_BAR; PG8_MMA(0, 0, At, B0); PG8_MMA(0, 1, At, B1); PG8_BAR; PG8_SCHED;
            PG8_LDA(At, 1, 1); PG8_STAGE(PG8_SB(1, 0), b3, voffB); PG8_STAGE(PG8_SB(1, 1), b3 + hstep, voffB); PG8_STAGE(PG8_SA(1, 0), a3, voffA);
            PG8_WAIT_V(8); PG8_WAIT_L(0); PG8_BAR; PG8_MMA(1, 0, At, B0); PG8_MMA(1, 1, At, B1); PG8_BAR; PG8_SCHED;
            } else {
            PG8_LDB(B0, 0, 0); PG8_SCHED; PG8_LDA(At, 0, 0); PG8_STAGE(PG8_SA(1, 1), a1 + hstep, voffA);
            PG8_WAIT_L(8); PG8_BAR; PG8_WAIT_L(0); PG8_MMA(0, 0, At, B0); PG8_BAR; PG8_SCHED;
            PG8_LDB(B1, 0, 1); PG8_STAGE(PG8_SB(0, 0), b2, voffB);
            PG8_BAR; PG8_WAIT_L(0); PG8_MMA(0, 1, At, B1); PG8_BAR;
            PG8_LDA(At, 0, 1); PG8_STAGE(PG8_SA(0, 0), a2, voffA);
            PG8_BAR; PG8_WAIT_L(0); PG8_MMA(1, 0, At, B0); PG8_BAR; PG8_SCHED;
            PG8_STAGE(PG8_SB(0, 1), b2 + hstep, voffB);
            PG8_WAIT_V(6); PG8_BAR; PG8_MMA(1, 1, At, B1); PG8_BAR;
            PG8_LDB(B0, 1, 0); PG8_SCHED; PG8_LDA(At, 1, 0); PG8_STAGE(PG8_SA(0, 1), a2 + hstep, voffA);
            PG8_WAIT_L(8); PG8_BAR; PG8_WAIT_L(0); PG8_MMA(0, 0, At, B0); PG8_BAR; PG8_SCHED;
            PG8_LDB(B1, 1, 1); PG8_STAGE(PG8_SB(1, 0), b3, voffB);
            PG8_BAR; PG8_WAIT_L(0); PG8_MMA(0, 1, At, B1); PG8_BAR;
            PG8_LDA(At, 1, 1); PG8_STAGE(PG8_SA(1, 0), a3, voffA);
            PG8_BAR; PG8_WAIT_L(0); PG8_MMA(1, 0, At, B0); PG8_BAR; PG8_SCHED;
            PG8_STAGE(PG8_SB(1, 1), b3 + hstep, voffB);
            PG8_WAIT_V(6); PG8_BAR; PG8_MMA(1, 1, At, B1); PG8_BAR;
            }
        }
        if constexpr (ALIGN_EPI) { if (wr == 0) PG8_BAR; }
        if constexpr (!Epi::AFTER_DRAIN) { E(acc, cur, wr, wc, fr, fq); S.done(cur); }
        if (!has_next) break;
#pragma unroll
        for (int a = 0; a < 2; ++a)
#pragma unroll
            for (int b = 0; b < 2; ++b)
#pragma unroll
                for (int m = 0; m < 4; ++m)
#pragma unroll
                    for (int n = 0; n < 2; ++n) acc[a][b][m][n] = (f32x4){0.f, 0.f, 0.f, 0.f};
        cur = nxt; cA = nA; cB = nB; ++ui;
        if constexpr (ALIGN_EPI) { if (wr == 1) PG8_BAR; }
    }
    PG8_WAIT_V(0);
    if constexpr (!ALIGN_EPI) { if (wr == 0) PG8_BAR; }
    PG8_BAR;
    if constexpr (Epi::AFTER_DRAIN) { E.fused(acc, cur, wr, wc, fr, fq, lds, wid, lane); S.done(cur); }
#undef PG8_SA
#undef PG8_SB
#undef PG8_STAGE
#undef PG8_LDA
#undef PG8_LDB
#undef PG8_MMA
#undef PG8_WAIT_V
#undef PG8_WAIT_L
#undef PG8_BAR
#undef PG8_SCHED
}
}
constexpr int BATCH = 8, SEQ = 4096, D = 1024, NH = 8, HD = 64, AW = 512, PW = 512, FF = 4096, PLE = 256;
constexpr int M = BATCH * SEQ;
constexpr float LN_EPS = 1e-5f, RMS_EPS = 1e-6f;
constexpr float DN_ALPHA = 1.189207115002721f;
constexpr int NWAVES = 8;
constexpr size_t MiB = 1u << 20;
constexpr size_t WS_WIN = 0, WS_WOUT = 4 * MiB, WS_WUP = 6 * MiB, WS_WDN = 14 * MiB, WS_WG = 22 * MiB, WS_WPLE = 24 * MiB;
constexpr size_t WS_X = 32 * MiB;
constexpr size_t WS_PB = 96 * MiB;
constexpr size_t WS_Y = 112 * MiB;
constexpr size_t WS_H = 240 * MiB;
constexpr size_t WS_Q = 240 * MiB, WS_K = 272 * MiB, WS_U = 304 * MiB, WS_VT = 336 * MiB, WS_MIX = 368 * MiB, WS_PLEB = 240 * MiB;
constexpr size_t WS_CTL = 28 * MiB, CTL_ZERO_BYTES = 65536;
constexpr size_t WS_END = 496 * MiB;
constexpr int LDS_BYTES = 147456;
#define GAS __attribute__((address_space(1)))
#define LAS __attribute__((address_space(3)))
typedef unsigned short bf16;
typedef unsigned v4u __attribute__((ext_vector_type(4)));
typedef float f32x4 __attribute__((ext_vector_type(4)));
typedef float f32x16 __attribute__((ext_vector_type(16)));
typedef short bf16x8 __attribute__((ext_vector_type(8)));
#define LDS_WAIT() asm volatile("s_waitcnt lgkmcnt(0)" ::: "memory")
__device__ __forceinline__ unsigned pk2(float lo, float hi) { return pg8::cvt_pk_bf16(lo, hi); }
__device__ __forceinline__ float wave_sum(float v) {
#pragma unroll
    for (int o = 1; o < 64; o <<= 1) v += __shfl_xor(v, o);
    return v;
}
__device__ __forceinline__ void transpose_item(const float* W, int ldw, int ncol0, int K, bf16* WT, int row_off, LAS float* scr, int kb, int nb, int lane) {
    const int k0 = 64 * kb, n0 = 32 * nb;
#pragma unroll 8
    for (int i = 0; i < 32; ++i) { const int kk = 2 * i + (lane >> 5); scr[kk * 33 + (lane & 31)] = W[(size_t)(k0 + kk) * ldw + ncol0 + n0 + (lane & 31)]; }
    LDS_WAIT(); asm volatile("" ::: "memory");
    const int c = lane & 7;
#pragma unroll
    for (int j = 0; j < 4; ++j) { const int n = (lane >> 3) + 8 * j; const LAS float* s = scr + (8 * c) * 33 + n;
        v4u o; o.x = pk2(s[0 * 33], s[1 * 33]); o.y = pk2(s[2 * 33], s[3 * 33]); o.z = pk2(s[4 * 33], s[5 * 33]); o.w = pk2(s[6 * 33], s[7 * 33]);
        *(v4u*)(WT + (size_t)(row_off + n0 + n) * K + k0 + 8 * c) = o; }
    LDS_WAIT(); asm volatile("" ::: "memory");
}
template <bool OUTF> __device__ __forceinline__ void ln_row(const float* xrow, const f32x4 (&g)[4], const f32x4 (&bb)[4], void* orow, int lane) {
    const f32x4* xr = (const f32x4*)xrow + lane;
    f32x4 v[4]; float s = 0.f;
#pragma unroll
    for (int j = 0; j < 4; ++j) { v[j] = xr[64 * j]; s += (v[j].x + v[j].y) + (v[j].z + v[j].w); }
    const float mean = wave_sum(s) * (1.f / D); float s2 = 0.f;
#pragma unroll
    for (int j = 0; j < 4; ++j) { v[j] = v[j] - mean; s2 += (v[j].x * v[j].x + v[j].y * v[j].y) + (v[j].z * v[j].z + v[j].w * v[j].w); }
    const float rstd = 1.f / sqrtf(wave_sum(s2) * (1.f / D) + LN_EPS);
#pragma unroll
    for (int j = 0; j < 4; ++j) { const f32x4 o = v[j] * rstd * g[j] + bb[j];
        if (OUTF) ((f32x4*)orow + lane)[64 * j] = o;
        else ((unsigned long long*)orow + lane)[64 * j] = (unsigned long long)pk2(o.x, o.y) | ((unsigned long long)pk2(o.z, o.w) << 32); }
}
template <bool OUTF> __device__ __forceinline__ void ln_phase(const float* Y, const float* g, const float* b, void* out, int gw, int ngw, int lane) {
    f32x4 gv[4], bv[4];
#pragma unroll
    for (int j = 0; j < 4; ++j) { gv[j] = ((const f32x4*)g + lane)[64 * j]; bv[j] = ((const f32x4*)b + lane)[64 * j]; }
    for (int m = gw; m < M; m += ngw) ln_row<OUTF>(Y + (size_t)m * D, gv, bv, OUTF ? (void*)((float*)out + (size_t)m * D) : (void*)((bf16*)out + (size_t)m * D), lane);
}
constexpr float LOG2E = 1.4426950408889634f, LN2 = 0.6931471805599453f;
constexpr float CARRY_STOP = -104.0f;
template <int W> __device__ __forceinline__ void pool_unit(const bf16* U, bf16* MIX, size_t rowbase, int t0, int ch) {
    float ext[31 + W];
#pragma unroll
    for (int i = 0; i < 31 + W; ++i) { const int t = t0 - (W - 1) + i; ext[i] = (t >= 0) ? __uint_as_float((unsigned)U[(rowbase + t) * PW + ch] << 16) : 0.f; }
    float win = 0.f;
#pragma unroll
    for (int i = 0; i < W - 1; ++i) win += ext[i];
#pragma unroll
    for (int i = 0; i < 32; ++i) { const int t = t0 + i; const float ut = ext[W - 1 + i]; win += ut;
        const int cnt = (t + 1 < W) ? t + 1 : W; const float o = win / (float)cnt - ut;
        MIX[(rowbase + t) * D + AW + ch] = (bf16)(pk2(o, 0.f) & 0xffffu);
        win -= ext[i]; }
}
__device__ __forceinline__ void attn_unit(const bf16* Q, const bf16* Kb, const bf16* Vt, const bf16* U, bf16* MIX, const float* attn_g, int b, int h, int qt, int lane) {
    const int qi = lane & 31, hh = lane >> 5;
    const int pi = (qi & 0x13) | ((qi & 4) << 1) | ((qi & 8) >> 1);
    const size_t rowbase = (size_t)b * SEQ; const int t0 = qt * 32;
    bf16x8 qf[4], tt[2];
    { const bf16* qp = Q + (rowbase + t0 + qi) * AW + h * HD + hh * 8;
#pragma unroll
      for (int s = 0; s < 4; ++s) qf[s] = *(const bf16x8*)(qp + 16 * s); }
#pragma unroll
    for (int s = 0; s < 2; ++s)
#pragma unroll
        for (int j = 0; j < 8; ++j) tt[s][j] = (16 * s + 8 * hh + j > pi) ? (short)0x3F80 : (short)0;
    const bf16* kp = Kb + (rowbase + pi) * AW + h * HD + hh * 8;
    const bf16* vp = Vt + (size_t)(h * HD + pi) * M + rowbase + hh * 8;
    f32x16 o0, o1;
#pragma unroll
    for (int r = 0; r < 16; ++r) { o0[r] = 0.f; o1[r] = 0.f; }
    float c = 0.f;
    bf16x8 kf[4], vf[2][2];
#pragma unroll
    for (int s = 0; s < 4; ++s) kf[s] = *(const bf16x8*)(kp + (size_t)t0 * AW + 16 * s);
#pragma unroll
    for (int dt = 0; dt < 2; ++dt)
#pragma unroll
        for (int s = 0; s < 2; ++s) vf[dt][s] = *(const bf16x8*)(vp + (size_t)dt * 32 * M + t0 + 16 * s);
    for (int kt = qt; kt >= 0; --kt) {
        const bool diag = (kt == qt);
        bf16x8 kn[4], vn[2][2];
        { const int sn = (kt > 0 ? kt - 1 : 0) * 32;
#pragma unroll
          for (int s = 0; s < 4; ++s) kn[s] = *(const bf16x8*)(kp + (size_t)sn * AW + 16 * s);
#pragma unroll
          for (int dt = 0; dt < 2; ++dt)
#pragma unroll
              for (int s = 0; s < 2; ++s) vn[dt][s] = *(const bf16x8*)(vp + (size_t)dt * 32 * M + sn + 16 * s); }
        f32x16 S;
#pragma unroll
        for (int r = 0; r < 16; ++r) S[r] = 0.f;
#pragma unroll
        for (int s = 0; s < 4; ++s) S = __builtin_amdgcn_mfma_f32_32x32x16_bf16(kf[s], qf[s], S, 0, 0, 0);
        float ln[16], lb[16];
#pragma unroll
        for (int r = 0; r < 16; ++r) { const float z = S[r];
            const float e = __builtin_amdgcn_exp2f(-fabsf(z) * LOG2E);
            const float sp = fmaf(__builtin_amdgcn_logf(1.f + e), LN2, fmaxf(z, 0.f));
            const int key = 16 * (r >> 3) + 8 * hh + (r & 7);
            const bool valid = !diag || (key < qi);
            ln[r] = valid ? -sp : 0.f;
            lb[r] = valid ? (z - sp) : -200.f; }
        unsigned lhi[8], llo[8];
#pragma unroll
        for (int i = 0; i < 8; ++i) { const unsigned hp = pk2(ln[2 * i], ln[2 * i + 1]); lhi[i] = hp; llo[i] = pk2(ln[2 * i] - pg8::bf_lo(hp), ln[2 * i + 1] - pg8::bf_hi(hp)); }
        f32x16 suf;
#pragma unroll
        for (int r = 0; r < 16; ++r) suf[r] = c;
        { const v4u h0 = {lhi[0], lhi[1], lhi[2], lhi[3]}, h1 = {lhi[4], lhi[5], lhi[6], lhi[7]}, l0 = {llo[0], llo[1], llo[2], llo[3]}, l1 = {llo[4], llo[5], llo[6], llo[7]};
          suf = __builtin_amdgcn_mfma_f32_32x32x16_bf16(tt[0], __builtin_bit_cast(bf16x8, h0), suf, 0, 0, 0);
          suf = __builtin_amdgcn_mfma_f32_32x32x16_bf16(tt[1], __builtin_bit_cast(bf16x8, h1), suf, 0, 0, 0);
          suf = __builtin_amdgcn_mfma_f32_32x32x16_bf16(tt[0], __builtin_bit_cast(bf16x8, l0), suf, 0, 0, 0);
          suf = __builtin_amdgcn_mfma_f32_32x32x16_bf16(tt[1], __builtin_bit_cast(bf16x8, l1), suf, 0, 0, 0); }
        unsigned pw[8];
#pragma unroll
        for (int i = 0; i < 8; ++i) pw[i] = pk2(__builtin_amdgcn_exp2f((lb[2 * i] + suf[2 * i]) * LOG2E), __builtin_amdgcn_exp2f((lb[2 * i + 1] + suf[2 * i + 1]) * LOG2E));
        { const v4u p0 = {pw[0], pw[1], pw[2], pw[3]}, p1 = {pw[4], pw[5], pw[6], pw[7]};
          o0 = __builtin_amdgcn_mfma_f32_32x32x16_bf16(vf[0][0], __builtin_bit_cast(bf16x8, p0), o0, 0, 0, 0);
          o0 = __builtin_amdgcn_mfma_f32_32x32x16_bf16(vf[0][1], __builtin_bit_cast(bf16x8, p1), o0, 0, 0, 0);
          o1 = __builtin_amdgcn_mfma_f32_32x32x16_bf16(vf[1][0], __builtin_bit_cast(bf16x8, p0), o1, 0, 0, 0);
          o1 = __builtin_amdgcn_mfma_f32_32x32x16_bf16(vf[1][1], __builtin_bit_cast(bf16x8, p1), o1, 0, 0, 0); }
        c = __shfl(suf[0] + ln[0], qi);
        if (__ballot(c >= CARRY_STOP) == 0ull) break;
#pragma unroll
        for (int s = 0; s < 4; ++s) kf[s] = kn[s];
#pragma unroll
        for (int dt = 0; dt < 2; ++dt)
#pragma unroll
            for (int s = 0; s < 2; ++s) vf[dt][s] = vn[dt][s];
    }
    float ss = 0.f;
#pragma unroll
    for (int r = 0; r < 16; ++r) ss += o0[r] * o0[r] + o1[r] * o1[r];
    ss += __shfl_xor(ss, 32);
    const float rs = 1.f / sqrtf(ss * (1.f / HD) + RMS_EPS);
    bf16* orow = MIX + (rowbase + t0 + qi) * D + h * HD + 8 * hh;
    const float* gp = attn_g + h * HD + 8 * hh;
#pragma unroll
    for (int dt = 0; dt < 2; ++dt)
#pragma unroll
        for (int s = 0; s < 2; ++s) { const f32x4 g0 = *(const f32x4*)(gp + 32 * dt + 16 * s), g1 = *(const f32x4*)(gp + 32 * dt + 16 * s + 4);
            const f32x16& o = dt ? o1 : o0; v4u w;
            w.x = pk2(o[8 * s + 0] * rs * g0.x, o[8 * s + 1] * rs * g0.y); w.y = pk2(o[8 * s + 2] * rs * g0.z, o[8 * s + 3] * rs * g0.w);
            w.z = pk2(o[8 * s + 4] * rs * g1.x, o[8 * s + 5] * rs * g1.y); w.w = pk2(o[8 * s + 6] * rs * g1.z, o[8 * s + 7] * rs * g1.w);
            *(v4u*)(orow + 32 * dt + 16 * s) = w; }
    const int ch = h * HD + lane;
    switch (h >> 1) { case 0: pool_unit<2>(U, MIX, rowbase, t0, ch); break; case 1: pool_unit<4>(U, MIX, rowbase, t0, ch); break;
                      case 2: pool_unit<8>(U, MIX, rowbase, t0, ch); break; default: pool_unit<16>(U, MIX, rowbase, t0, ch); break; }
}
#define XB_TMO      128
#define XB_XCNT(j)  (256  + 64 * (j))
#define XB_XSUB(j)  (1280 + 64 * (j))
#define XB_XGEN(j)  (2304 + 64 * (j))
#define XB_TOP      3328
#define XB_TOPGEN   3392
#define XCD_BAR_WORDS 3456
#define XB_SPIN_CAP (1u << 18)

__device__ __forceinline__ unsigned xb_ld(unsigned* p)              { return __hip_atomic_load(p, __ATOMIC_RELAXED, __HIP_MEMORY_SCOPE_AGENT); }
__device__ __forceinline__ unsigned xb_add(unsigned* p, unsigned v) { return __hip_atomic_fetch_add(p, v, __ATOMIC_RELAXED, __HIP_MEMORY_SCOPE_AGENT); }
__device__ __forceinline__ unsigned xb_xcc_id() { return (unsigned)__builtin_amdgcn_s_getreg((3 << 11) | 20) & 0xFu; }
#define XB_SPIN(cond, bar) do { unsigned _sp = 0; while (cond) { __builtin_amdgcn_s_sleep(1); \
    if ((++_sp & 255u) == 0u) { if (xb_ld(&(bar)[XB_TMO])) break; if (_sp > XB_SPIN_CAP) { atomicAdd(&(bar)[XB_TMO], 1u); break; } } } } while (0)

struct XcdBarrier {
    unsigned* bar; unsigned x;
    volatile LAS unsigned* st;
};

__device__ __forceinline__ XcdBarrier xcd_barrier_post(unsigned* bar, volatile LAS unsigned* st) {
    XcdBarrier b; b.bar = bar; b.x = xb_xcc_id(); b.st = st;
    if (threadIdx.x == 0) (void)xb_add(&bar[XB_XCNT(b.x)], 1u);
    return b;
}
__device__ __forceinline__ void xcd_barrier_complete(unsigned* bar, unsigned x, unsigned& nloc, unsigned& nx) {
    const unsigned G = gridDim.x * gridDim.y * gridDim.z;
    unsigned sum, cnt, mine, sp = 0u;
    for (;;) {
        sum = 0u; cnt = 0u; mine = 0u;
#pragma unroll
        for (unsigned j = 0; j < 16; ++j) { const unsigned c = xb_ld(&bar[XB_XCNT(j)]); sum += c; cnt += (c > 0u) ? 1u : 0u; mine = (j == x) ? c : mine; }
        if (sum == G) break;
        __builtin_amdgcn_s_sleep(1);
        if ((++sp & 255u) == 0u) { if (xb_ld(&bar[XB_TMO])) break; if (sp > XB_SPIN_CAP) { atomicAdd(&bar[XB_TMO], 1u); break; } }
    }
    nloc = mine > 0u ? mine : 1u; nx = cnt > 0u ? cnt : 1u;
}

__device__ __forceinline__ void xcd_barrier(const XcdBarrier& b) {
    asm volatile("s_waitcnt vmcnt(0)" ::: "memory");
    __syncthreads();
    if (threadIdx.x == 0) {
        unsigned* bar = b.bar;
        __builtin_amdgcn_s_waitcnt(0);
        unsigned nloc = b.st[0], nx = b.st[1];
        if (nloc == 0u) { xcd_barrier_complete(bar, b.x, nloc, nx); b.st[0] = nloc; b.st[1] = nx; }
        const unsigned old = xb_add(&bar[XB_XSUB(b.x)], 1u);
        const unsigned gen = old / nloc;
        if (old + 1u == (gen + 1u) * nloc) {
            __builtin_amdgcn_fence(__ATOMIC_RELEASE, "agent");
            asm volatile("s_waitcnt vmcnt(0)" ::: "memory");
            const unsigned og = xb_add(&bar[XB_TOP], 1u);
            const unsigned tg = og / nx;
            if (og + 1u == (tg + 1u) * nx) xb_add(&bar[XB_TOPGEN], 1u);
            else XB_SPIN(xb_ld(&bar[XB_TOPGEN]) == tg, bar);
            __builtin_amdgcn_fence(__ATOMIC_ACQUIRE, "agent");
            xb_add(&bar[XB_XGEN(b.x)], 1u);
            asm volatile("s_waitcnt vmcnt(0)" ::: "memory");
        } else {
            XB_SPIN(xb_ld(&bar[XB_XGEN(b.x)]) == gen, bar);
            __builtin_amdgcn_fence(__ATOMIC_ACQUIRE, "agent");
            asm volatile("s_waitcnt vmcnt(0)" ::: "memory");
        }
    }
    __syncthreads();
}

#define GSYNC() xcd_barrier(bar)
struct Args { const float* in[19]; float* out; unsigned char* ws; };
__global__ void __launch_bounds__(NWAVES * 64, 2) fwd_kernel(Args a) {
    extern __shared__ __attribute__((aligned(16))) unsigned char lds_raw[];
    cg::grid_group grid = cg::this_grid();
    LAS unsigned char* lds = (LAS unsigned char*)lds_raw;
    const int tid = threadIdx.x, lane = tid & 63, wave = __builtin_amdgcn_readfirstlane(tid >> 6);
    const int G = gridDim.x, bx = blockIdx.x;
    const int gw = bx * NWAVES + wave, ngw = G * NWAVES;
    unsigned char* ws = a.ws;
    const float *x = a.in[0], *p = a.in[1], *ln0g = a.in[2], *ln0b = a.in[3], *w_in = a.in[4], *attn_g = a.in[5], *w_pool = a.in[6], *pool_scale = a.in[7], *w_out = a.in[8],
                *ln1g = a.in[9], *ln1b = a.in[10], *w_up = a.in[11], *w_dn = a.in[12], *ln2g = a.in[13], *ln2b = a.in[14], *w_ple = a.in[15], *w_g = a.in[16], *ln3g = a.in[17], *ln3b = a.in[18];
    bf16 *WinT = (bf16*)(ws + WS_WIN), *WoutT = (bf16*)(ws + WS_WOUT), *WupT = (bf16*)(ws + WS_WUP), *WdnT = (bf16*)(ws + WS_WDN), *WgT = (bf16*)(ws + WS_WG), *WpleT = (bf16*)(ws + WS_WPLE);
    bf16 *X = (bf16*)(ws + WS_X), *PB = (bf16*)(ws + WS_PB), *H = (bf16*)(ws + WS_H), *Qb = (bf16*)(ws + WS_Q), *Kb = (bf16*)(ws + WS_K), *Ub = (bf16*)(ws + WS_U), *Vt = (bf16*)(ws + WS_VT),
         *MIX = (bf16*)(ws + WS_MIX), *PLEB = (bf16*)(ws + WS_PLEB);
    float* Y = (float*)(ws + WS_Y);
    volatile LAS unsigned* MISC = (volatile LAS unsigned*)(lds + 131072 + 320);
    if (tid < 32) MISC[tid] = 0u;
    __syncthreads();
    XcdBarrier bar = xcd_barrier_post((unsigned*)(ws + WS_CTL), MISC + 8);
    grid.sync();

    {
        LAS float* scr = (LAS float*)(lds + wave * 16384);
        constexpr int I_QK = (D / 64) * (1024 / 32), I_V = (D / 64) * (512 / 32), I_O = (D / 64) * (D / 32), I_UP = (D / 64) * (FF / 32), I_DN = (FF / 64) * (D / 32), I_G = I_O, I_PL = (PLE / 64) * (D / 32);
        constexpr int NT = I_QK + I_V + I_O + I_UP + I_DN + I_G + I_PL;
        for (int it = gw; it < NT; it += ngw) {
            int r = it;
            if (r < I_QK) { transpose_item(w_in, 2048, 0, D, WinT, 0, scr, r / 32, r % 32, lane); continue; } r -= I_QK;
            if (r < I_V)  { transpose_item(w_in, 2048, 1024, D, WinT, 1536, scr, r / 16, r % 16, lane); continue; } r -= I_V;
            if (r < I_O)  { transpose_item(w_out, D, 0, D, WoutT, 0, scr, r / 32, r % 32, lane); continue; } r -= I_O;
            if (r < I_UP) { transpose_item(w_up, FF, 0, D, WupT, 0, scr, r / 128, r % 128, lane); continue; } r -= I_UP;
            if (r < I_DN) { transpose_item(w_dn, D, 0, FF, WdnT, 0, scr, r / 32, r % 32, lane); continue; } r -= I_DN;
            if (r < I_G)  { transpose_item(w_g, D, 0, D, WgT, 0, scr, r / 32, r % 32, lane); continue; } r -= I_G;
            transpose_item(w_ple, D, 0, PLE, WpleT, 0, scr, r / 32, r % 32, lane);
        }
        for (int it = gw; it < 8 * 128; it += ngw) {
            const int nb = it & 7, k0 = (it >> 3) * 8, n = nb * 64 + lane, g = nb >> 1, nn = n & 127;
            const float* wp = w_pool + (size_t)g * 128 * 128 + nn; const float* wi = w_in + (size_t)k0 * 2048 + 1536 + g * 128;
            float acc[8];
#pragma unroll
            for (int i = 0; i < 8; ++i) acc[i] = 0.f;
#pragma unroll 4
            for (int c = 0; c < 128; ++c) { const float wv = wp[(size_t)c * 128];
#pragma unroll
                for (int i = 0; i < 8; ++i) acc[i] = fmaf(wi[(size_t)i * 2048 + c], wv, acc[i]); }
            const float ps = pool_scale[n];
            v4u o; o.x = pk2(acc[0] * ps, acc[1] * ps); o.y = pk2(acc[2] * ps, acc[3] * ps); o.z = pk2(acc[4] * ps, acc[5] * ps); o.w = pk2(acc[6] * ps, acc[7] * ps);
            *(v4u*)(WinT + (size_t)(1024 + n) * D + k0) = o;
        }
        ln_phase<false>(x, ln0g, ln0b, X, gw, ngw, lane);
        for (size_t i = (size_t)gw * 64 + lane; i < (size_t)M * PLE / 8; i += (size_t)ngw * 64) {
            const f32x4 v0 = ((const f32x4*)p)[2 * i], v1 = ((const f32x4*)p)[2 * i + 1];
            v4u o; o.x = pk2(v0.x, v0.y); o.y = pk2(v0.z, v0.w); o.z = pk2(v1.x, v1.y); o.w = pk2(v1.z, v1.w); ((v4u*)PB)[i] = o; }
    }
    GSYNC();
    {
        pg8::Gemm g{X, WinT, M, 1536, D}; pg8::StaticOrder S; S.init(M, 1536, G, bx);
        pg8::EpiBf16<0> E{Qb, AW, 512, (size_t)(WS_K - WS_Q) / 2, 0.125f};
        pg8::gemm_phase<pg8::EpiBf16<0>, pg8::StaticOrder, true, true>(lds, g, S, E);
        pg8::Gemm g2{WinT + (size_t)1536 * D, X, 512, M, D}; pg8::StaticOrder S2; S2.init(512, M, G, bx);
        pg8::EpiBf16<0> E2{Vt, M, 0, 0, 1.f};
        pg8::gemm_phase<pg8::EpiBf16<0>, pg8::StaticOrder, true, true>(lds, g2, S2, E2);
    }
    GSYNC();
    for (int wu = bx; wu < BATCH * NH * (SEQ / 256); wu += G) {
        const int bh = wu / (SEQ / 256), qb = wu % (SEQ / 256);
        attn_unit(Qb, Kb, Vt, Ub, MIX, attn_g, bh / NH, bh % NH, qb * 8 + wave, lane);
    }
    GSYNC();
    {
        pg8::Gemm g{MIX, WoutT, M, D, D}; pg8::StaticOrder S; S.init(M, D, G, bx);
        pg8::EpiRes E{X, Y, D, DN_ALPHA};
        pg8::gemm_phase<pg8::EpiRes, pg8::StaticOrder, true, true>(lds, g, S, E);
    }
    GSYNC();
    ln_phase<false>(Y, ln1g, ln1b, X, gw, ngw, lane);
    GSYNC();
    {
        pg8::Gemm g{X, WupT, M, FF, D}; pg8::StaticOrder S; S.init(M, FF, G, bx);
        pg8::EpiBf16<2> E{H, FF, 0, 0, 1.f};
        pg8::gemm_phase<pg8::EpiBf16<2>, pg8::StaticOrder, true, true>(lds, g, S, E);
    }
    GSYNC();
    {
        pg8::Gemm g{H, WdnT, M, D, FF}; pg8::StaticOrder S; S.init(M, D, G, bx);
        pg8::EpiRes E{X, Y, D, DN_ALPHA};
        pg8::gemm_phase<pg8::EpiRes, pg8::StaticOrder, true, true>(lds, g, S, E);
    }
    GSYNC();
    ln_phase<false>(Y, ln2g, ln2b, X, gw, ngw, lane);
    GSYNC();
    {
        pg8::Gemm g{PB, WpleT, M, D, PLE}; pg8::StaticOrder S; S.init(M, D, G, bx);
        pg8::EpiBf16<0> E{PLEB, D, 0, 0, 1.f};
        pg8::gemm_phase<pg8::EpiBf16<0>, pg8::StaticOrder, true, true>(lds, g, S, E);
        asm volatile("s_waitcnt vmcnt(0)" ::: "memory"); __syncthreads();
        pg8::Gemm g2{X, WgT, M, D, D};
        pg8::EpiGate E2{X, PLEB, Y, D, DN_ALPHA};
        pg8::gemm_phase<pg8::EpiGate, pg8::StaticOrder, true, true>(lds, g2, S, E2);
    }
    GSYNC();
    ln_phase<true>(Y, ln3g, ln3b, a.out, gw, ngw, lane);
}
extern "C" void kernel_launch(void* const* d_in, const int* in_sizes, int n_in, void* d_out, int out_size, void* d_ws, size_t ws_size, hipStream_t stream) {
    static int grid = 0;
    if (grid == 0) {
        if (n_in != 19 || in_sizes[0] != M * D || out_size != M * D || ws_size < WS_END) { fprintf(stderr, "kernel_launch: unexpected shapes / workspace (%d inputs, ws %zu)\n", n_in, ws_size); grid = -1; return; }
        int dev = 0, cus = 0, per_cu = 0;
        (void)hipGetDevice(&dev); (void)hipDeviceGetAttribute(&cus, hipDeviceAttributeMultiprocessorCount, dev);
        (void)hipFuncSetAttribute((const void*)fwd_kernel, hipFuncAttributeMaxDynamicSharedMemorySize, LDS_BYTES);
        if (hipOccupancyMaxActiveBlocksPerMultiprocessor(&per_cu, (const void*)fwd_kernel, NWAVES * 64, LDS_BYTES) != hipSuccess || per_cu < 1) per_cu = 1;
        (void)hipGetLastError();
        grid = cus * (per_cu > 1 ? 1 : per_cu);
    }
    if (grid < 0) return;
    if (hipMemsetAsync((char*)d_ws + WS_CTL, 0, CTL_ZERO_BYTES, stream) != hipSuccess) { fprintf(stderr, "memset failed\n"); return; }
    Args a{};
    for (int i = 0; i < 19; ++i) a.in[i] = (const float*)d_in[i];
    a.out = (float*)d_out; a.ws = (unsigned char*)d_ws;
    void* args[] = {&a};
    hipError_t e = hipLaunchCooperativeKernel((const void*)fwd_kernel, dim3(grid), dim3(NWAVES * 64), args, LDS_BYTES, stream);
    if (e != hipSuccess) fprintf(stderr, "cooperative launch failed: %s (grid %d)\n", hipGetErrorString(e), grid);
}
```
